# Optimizing an MI355X kernel written in HIP

```python
import math
import jax, jax.numpy as jnp
from jax import lax
import numpy as np

D_MODEL = 1024
BATCH = 8
SEQ = 4096
DEPTH = 1

MLA_HEADS = 8
MLA_NOPE = 64
MLA_ROPE = 32
MLA_V = 64
MLA_Q_RANK = 384
MLA_KV_RANK = 256
RET_HEADS = 4
RET_DK = 64
RET_DV = 128
RET_CHUNK = 128
FF_DIM = 2816
Q_BLOCK = 128
ROPE_BASE = 10000.0
NORM_EPS = 1e-6
GN_EPS = 1e-6

IN_SIZES = (MLA_Q_RANK, MLA_KV_RANK, MLA_ROPE,
            RET_HEADS * RET_DK, RET_HEADS * RET_DK, RET_HEADS * RET_DV, RET_HEADS * RET_DV,
            D_MODEL, D_MODEL)
IN_WIDTH = sum(IN_SIZES)

kernel_name = "hybrid_mla_retention_gated_macaron"


def _rmsnorm(x, w):
    xf = x.astype(jnp.float32)
    y = xf * lax.rsqrt(jnp.mean(xf * xf, axis=-1, keepdims=True) + NORM_EPS)
    return (y * w.astype(jnp.float32)).astype(x.dtype)


def _swiglu(x, w1, w2):
    gate, up = jnp.split(x @ w1, 2, axis=-1)
    return (jax.nn.silu(gate) * up) @ w2


def _rope(x, positions):
    half = x.shape[-1] // 2
    inv_freq = ROPE_BASE ** (-jnp.arange(half, dtype=jnp.float32) / half)
    ang = positions.astype(jnp.float32)[..., None] * inv_freq
    cos = jnp.cos(ang)[:, :, None, :]
    sin = jnp.sin(ang)[:, :, None, :]
    xf = x.astype(jnp.float32)
    x1, x2 = xf[..., :half], xf[..., half:]
    return jnp.concatenate([x1 * cos - x2 * sin, x2 * cos + x1 * sin], axis=-1).astype(x.dtype)


def _split_points():
    points, acc = [], 0
    for s in IN_SIZES[:-1]:
        acc += s
        points.append(acc)
    return points


def _causal_attention(q, k, v, scale):
    b, h, s, dqk = q.shape
    nb = s // Q_BLOCK
    q_blocks = jnp.moveaxis(q.reshape(b, h, nb, Q_BLOCK, dqk), 2, 0)
    k_pos = jnp.arange(s)

    def one_block(args):
        q_blk, i = args
        scores = jnp.einsum('bhqd,bhkd->bhqk', q_blk, k).astype(jnp.float32) * scale
        q_pos = i * Q_BLOCK + jnp.arange(Q_BLOCK)
        scores = jnp.where(q_pos[:, None] >= k_pos[None, :], scores, -jnp.inf)
        p = jax.nn.softmax(scores, axis=-1)
        return jnp.einsum('bhqk,bhkd->bhqd', p.astype(v.dtype), v)

    out = lax.map(one_block, (q_blocks, jnp.arange(nb)))
    return jnp.moveaxis(out, 0, 2).reshape(b, h, s, v.shape[-1])


def _chunkwise_retention(q, k, v):
    b, h, s, dk = q.shape
    dv = v.shape[-1]
    n = s // RET_CHUNK
    log_gamma = jnp.log(1.0 - 2.0 ** (-5.0 - jnp.arange(h, dtype=jnp.float32)))
    idx = jnp.arange(RET_CHUNK, dtype=jnp.float32)
    diff = idx[:, None] - idx[None, :]
    decay_intra = jnp.where(diff >= 0, jnp.exp(jnp.maximum(diff, 0.0) * log_gamma[:, None, None]), 0.0)
    zeta = jnp.exp((RET_CHUNK - 1 - idx) * log_gamma[:, None])
    xi = jnp.exp((idx + 1.0) * log_gamma[:, None])
    chunk_decay = jnp.exp(RET_CHUNK * log_gamma)

    qc = q.reshape(b, h, n, RET_CHUNK, dk)
    kc = k.reshape(b, h, n, RET_CHUNK, dk)
    vc = v.reshape(b, h, n, RET_CHUNK, dv)

    inner = jnp.einsum('bhncd,bhnsd->bhncs', qc, kc) * decay_intra[None, :, None].astype(q.dtype)
    y_inner = jnp.einsum('bhncs,bhnse->bhnce', inner, vc)

    kv = jnp.einsum('bhnsd,bhnse->bhnde', kc * zeta[None, :, None, :, None].astype(k.dtype), vc)
    decay_c = chunk_decay.astype(kv.dtype)[None, :, None, None]

    def step(state, kv_n):
        return state * decay_c + kv_n, state

    _, r_prev = lax.scan(step, jnp.zeros_like(kv[:, :, 0]), jnp.moveaxis(kv, 2, 0))
    r_prev = jnp.moveaxis(r_prev, 0, 2)
    y_cross = jnp.einsum('bhncd,bhnde->bhnce', qc, r_prev) * xi[None, :, None, :, None].astype(q.dtype)
    y = (y_inner + y_cross).reshape(b, h, s, dv)

    yf = y.astype(jnp.float32)
    mu = jnp.mean(yf, axis=-1, keepdims=True)
    var = jnp.mean(jnp.square(yf - mu), axis=-1, keepdims=True)
    return ((yf - mu) * lax.rsqrt(var + GN_EPS)).astype(v.dtype)


def _token_mixer(h, positions, w_in, mla_q_norm_w, mla_w_uq, mla_kv_norm_w, mla_w_ukv,
                 ret_gn_w, w_branch_mla, w_branch_ret, w_out):
    b, s, _ = h.shape
    proj = h @ w_in
    c_q, c_kv, k_rope_raw, rq, rk, rv, rg, gate_mla, gate_ret = jnp.split(proj, _split_points(), axis=-1)

    q = (_rmsnorm(c_q, mla_q_norm_w) @ mla_w_uq).reshape(b, s, MLA_HEADS, MLA_NOPE + MLA_ROPE)
    q = jnp.concatenate([q[..., :MLA_NOPE], _rope(q[..., MLA_NOPE:], positions)], axis=-1)
    kv = (_rmsnorm(c_kv, mla_kv_norm_w) @ mla_w_ukv).reshape(b, s, MLA_HEADS, MLA_NOPE + MLA_V)
    k_nope, v_mla = kv[..., :MLA_NOPE], kv[..., MLA_NOPE:]
    k_rope = _rope(k_rope_raw[:, :, None, :], positions)
    k = jnp.concatenate([k_nope, jnp.broadcast_to(k_rope, (b, s, MLA_HEADS, MLA_ROPE))], axis=-1)
    o_mla = _causal_attention(q.transpose(0, 2, 1, 3), k.transpose(0, 2, 1, 3),
                              v_mla.transpose(0, 2, 1, 3), 1.0 / math.sqrt(MLA_NOPE + MLA_ROPE))
    o_mla = o_mla.transpose(0, 2, 1, 3).reshape(b, s, MLA_HEADS * MLA_V) @ w_branch_mla

    rq = _rope(rq.reshape(b, s, RET_HEADS, RET_DK), positions).transpose(0, 2, 1, 3)
    rk = (_rope(rk.reshape(b, s, RET_HEADS, RET_DK), positions) * (RET_DK ** -0.5)).transpose(0, 2, 1, 3)
    rv = rv.reshape(b, s, RET_HEADS, RET_DV).transpose(0, 2, 1, 3)
    y_ret = _chunkwise_retention(rq, rk, rv).transpose(0, 2, 1, 3).reshape(b, s, RET_HEADS * RET_DV)
    o_ret = (jax.nn.silu(rg) * (y_ret * ret_gn_w)) @ w_branch_ret

    merged = jax.nn.sigmoid(gate_mla) * o_mla + jax.nn.sigmoid(gate_ret) * o_ret
    return merged @ w_out


def setup_inputs(seed: int = 0) -> dict:
    key = jax.random.key(seed)
    ks = jax.random.split(key, 24)
    f32 = jnp.float32

    def w(k, shape, fan_in):
        return jax.random.normal(k, (DEPTH,) + shape, f32) * (fan_in ** -0.5)

    def gain(k, n):
        return 1.0 + 0.02 * jax.random.normal(k, (DEPTH, n), f32)

    return {
        "x": jax.random.normal(ks[0], (BATCH, SEQ, D_MODEL), f32),
        "positions": jnp.broadcast_to(jnp.arange(SEQ, dtype=jnp.int32), (BATCH, SEQ)),
        "ffn1_pre_w": gain(ks[1], D_MODEL),
        "ffn1_w1": w(ks[2], (D_MODEL, 2 * FF_DIM), D_MODEL),
        "ffn1_w2": w(ks[3], (FF_DIM, D_MODEL), FF_DIM),
        "ffn1_post_w": gain(ks[4], D_MODEL),
        "mix_pre_w": gain(ks[5], D_MODEL),
        "w_in": w(ks[6], (D_MODEL, IN_WIDTH), D_MODEL),
        "mla_q_norm_w": gain(ks[7], MLA_Q_RANK),
        "mla_w_uq": w(ks[8], (MLA_Q_RANK, MLA_HEADS * (MLA_NOPE + MLA_ROPE)), MLA_Q_RANK),
        "mla_kv_norm_w": gain(ks[9], MLA_KV_RANK),
        "mla_w_ukv": w(ks[10], (MLA_KV_RANK, MLA_HEADS * (MLA_NOPE + MLA_V)), MLA_KV_RANK),
        "ret_gn_w": gain(ks[11], RET_HEADS * RET_DV),
        "w_branch_mla": w(ks[12], (MLA_HEADS * MLA_V, D_MODEL), MLA_HEADS * MLA_V),
        "w_branch_ret": w(ks[13], (RET_HEADS * RET_DV, D_MODEL), RET_HEADS * RET_DV),
        "w_out": w(ks[14], (D_MODEL, D_MODEL), D_MODEL),
        "mix_post_w": gain(ks[15], D_MODEL),
        "ffn2_pre_w": gain(ks[16], D_MODEL),
        "ffn2_w1": w(ks[17], (D_MODEL, 2 * FF_DIM), D_MODEL),
        "ffn2_w2": w(ks[18], (FF_DIM, D_MODEL), FF_DIM),
        "ffn2_post_w": gain(ks[19], D_MODEL),
    }


def reference(x, positions, ffn1_pre_w, ffn1_w1, ffn1_w2, ffn1_post_w, mix_pre_w, w_in,
              mla_q_norm_w, mla_w_uq, mla_kv_norm_w, mla_w_ukv, ret_gn_w, w_branch_mla,
              w_branch_ret, w_out, mix_post_w, ffn2_pre_w, ffn2_w1, ffn2_w2, ffn2_post_w):
    h = x
    for l in range(DEPTH):
        f = _swiglu(_rmsnorm(h, ffn1_pre_w[l]), ffn1_w1[l], ffn1_w2[l])
        h = h + 0.5 * _rmsnorm(f, ffn1_post_w[l])
        m = _token_mixer(_rmsnorm(h, mix_pre_w[l]), positions, w_in[l], mla_q_norm_w[l], mla_w_uq[l],
                         mla_kv_norm_w[l], mla_w_ukv[l], ret_gn_w[l], w_branch_mla[l],
                         w_branch_ret[l], w_out[l])
        h = h + _rmsnorm(m, mix_post_w[l])
        f = _swiglu(_rmsnorm(h, ffn2_pre_w[l]), ffn2_w1[l], ffn2_w2[l])
        h = h + 0.5 * _rmsnorm(f, ffn2_post_w[l])
    return h
```

```cpp
#include <hip/hip_runtime.h>
#include <cstdio>
#include <cstdint>
#include <cmath>
constexpr int NWAVES = 8;
constexpr int M_TOK = 32768, DM = 1024, FF = 2816, NWIN = 4352;
constexpr size_t MiB = 1u << 20;
constexpr size_t WS_CTL = 0, CTL_ZERO_BYTES = 2 * MiB;
constexpr size_t WS_SSQQ = 1 * MiB, WS_SSQKV = 1 * MiB + 128 * 1024;
constexpr size_t WS_TABM = 2 * MiB, WS_TABR = 6 * MiB;
constexpr size_t WS_W1A = 14 * MiB, WS_W2A = 25 * MiB, WS_WIN = 31 * MiB, WS_WUQ = 40 * MiB, WS_WUKV = 41 * MiB, WS_WBM = 42 * MiB, WS_WBR = 43 * MiB, WS_WOUT = 44 * MiB, WS_W1B = 46 * MiB, WS_W2B = 57 * MiB;
constexpr size_t WS_XN = 64 * MiB;
constexpr size_t WS_R = 128 * MiB;
constexpr size_t WS_GM = WS_R, WS_GR = WS_R + 64 * MiB, WS_RV = WS_R + 128 * MiB, WS_SG = WS_R + 160 * MiB, WS_RQ = WS_R + 192 * MiB, WS_RK = WS_R + 208 * MiB, WS_KR = WS_R + 224 * MiB,
                 WS_Q = WS_R + 226 * MiB, WS_KVN = WS_R + 274 * MiB, WS_CQ = WS_R + 306 * MiB, WS_CKV = WS_R + 330 * MiB, WS_AO = WS_R + 306 * MiB, WS_YG = WS_R + 338 * MiB;
constexpr size_t WS_KN = WS_XN, WS_V = WS_XN + 32 * MiB, WS_MG = WS_XN;
constexpr size_t WS_H = WS_R + 64 * MiB, WS_F = WS_R + 240 * MiB, WS_T1 = WS_R + 128 * MiB;
constexpr size_t WS_END = 512 * MiB;
constexpr int CW_BAR = 4096;
constexpr int LDS_TOTAL = 147456, RING_BYTES = 131072, MISC_OFF = RING_BYTES + 320;


__device__ __forceinline__ int tid_fresh(int wv) { int l; asm volatile("v_mbcnt_lo_u32_b32 %0, -1, 0\n\tv_mbcnt_hi_u32_b32 %0, -1, %0" : "=v"(l)); return wv * 64 + l; }
namespace pg8 {
#define PG8_LAS __attribute__((address_space(3)))
typedef unsigned short bf16_t;
typedef short bf16x8 __attribute__((ext_vector_type(8)));
typedef float f32x4 __attribute__((ext_vector_type(4)));
typedef unsigned u32x4 __attribute__((ext_vector_type(4)));
constexpr int BM = 256, BK = 64, HALF = 128, HTB = HALF * BK * 2  , STAGE_BYTES = 8 * HTB, NXCD = 8, WGM = 8;

__host__ __device__ __forceinline__ int lds_byte(int r, int c) { const int st = (r >> 4) * 2 + (c >> 5), rr = r & 15, cc = c & 31, ob = rr * 64 + cc * 2; return st * 1024 + (ob ^ (((ob >> 9) & 1) << 5)); }
__host__ __device__ __forceinline__ void stage_rc(int b, int& R, int& C) { const int st = b / 1024, sb = b % 1024, swz = sb ^ (((sb >> 9) & 1) << 5); R = (st >> 1) * 16 + swz / 64; C = (st & 1) * 32 + (swz % 64) / 2; }
__host__ __device__ __forceinline__ int perm32(int rho) { const int n = rho >> 4, i = rho & 15; return 8 * (i >> 2) + 4 * n + (i & 3); }

struct Unit { int pm, pn; };
struct Gemm { const bf16_t* A; const bf16_t* Bt; int M, N, K; };

struct StaticOrder {
    int nM, nN, nwg, G, c;
    __host__ __device__ void init(int M, int N, int G_, int c_) { nM = M / BM; nN = N / BM; nwg = nM * nN; G = G_; c = c_; }
    __host__ __device__ bool next(int i, Unit& u) const {
        const long L = (long)i * G + c; if (L >= nwg) return false;
        int wgid = (int)L; { const int q = nwg / NXCD, r = nwg % NXCD, xcd = wgid % NXCD, off = wgid / NXCD; wgid = (xcd < r ? xcd * (q + 1) : r * (q + 1) + (xcd - r) * q) + off; }
        const int nig = WGM * nN, gid = wgid / nig, fm = gid * WGM, gsz = (nM - fm) < WGM ? (nM - fm) : WGM;
        u.pm = fm + ((wgid % nig) % gsz); u.pn = (wgid % nig) / gsz; return true;
    }
    __device__ __forceinline__ void a_ready(const Unit&) const {}
    __device__ __forceinline__ void done(const Unit&) const {}
};

__device__ __forceinline__ unsigned cvt_pk_bf16(float lo, float hi) { unsigned r; asm volatile("v_cvt_pk_bf16_f32 %0, %1, %2" : "=v"(r) : "v"(lo), "v"(hi)); return r; }
typedef float f32x2 __attribute__((ext_vector_type(2)));

__device__ __forceinline__ void st8(bf16_t* p, const f32x4 a, const f32x4 b) {
    u32x4 w; w.x = cvt_pk_bf16(a[0], a[1]); w.y = cvt_pk_bf16(a[2], a[3]); w.z = cvt_pk_bf16(b[0], b[1]); w.w = cvt_pk_bf16(b[2], b[3]);
    *(u32x4*)p = w;
}
__device__ __forceinline__ int fresh_lane() { int l; asm volatile("v_mbcnt_lo_u32_b32 %0, -1, 0\n\tv_mbcnt_hi_u32_b32 %0, -1, %0" : "=v"(l)); return l; }
__device__ __forceinline__ float sigm(float x) { return __builtin_amdgcn_rcpf(1.0f + __expf(-x)); }
__device__ __forceinline__ f32x4 sigm4(const f32x4 v) { return (f32x4){sigm(v[0]), sigm(v[1]), sigm(v[2]), sigm(v[3])}; }
__device__ __forceinline__ f32x4 silu4(const f32x4 v) { return v * sigm4(v); }
__device__ __forceinline__ float sq4(const f32x4 v) { return (v[0] * v[0] + v[1] * v[1]) + (v[2] * v[2] + v[3] * v[3]); }
__device__ __forceinline__ f32x4 bf4_to_f32(unsigned lo, unsigned hi) {
    return (f32x4){__uint_as_float(lo << 16), __uint_as_float(lo & 0xffff0000u), __uint_as_float(hi << 16), __uint_as_float(hi & 0xffff0000u)};
}
__device__ __forceinline__ f32x4 shx4(const f32x4 v, int m) { return (f32x4){__shfl_xor(v[0], m), __shfl_xor(v[1], m), __shfl_xor(v[2], m), __shfl_xor(v[3], m)}; }

struct EpiF32 {
    static constexpr bool PERM = false, AFTER_DRAIN = false;
    float* C; int ldc;
    __device__ __forceinline__ void operator()(const f32x4 (&acc)[2][2][4][2], const Unit& u, int wr, int wc, int fr, int fq) const {
        const int row0 = u.pm * BM + wr * 64 + fr, col0 = u.pn * BM + wc * 32 + 4 * fq;
#pragma unroll
        for (int ai = 0; ai < 2; ++ai)
#pragma unroll
            for (int m = 0; m < 4; ++m) { float* rowp = C + (size_t)(row0 + ai * HALF + m * 16) * ldc + col0;
#pragma unroll
                for (int bj = 0; bj < 2; ++bj)
#pragma unroll
                    for (int n = 0; n < 2; ++n) *(f32x4*)(rowp + bj * HALF + n * 16) = acc[ai][bj][m][n]; asm volatile("" ::: "memory"); }
    }
};

struct EpiSwiGLU {
    static constexpr bool PERM = true, AFTER_DRAIN = false;
    bf16_t* O; int ldc;
    __device__ __forceinline__ void operator()(const f32x4 (&acc)[2][2][4][2], const Unit& u, int wr, int wc, int fr, int fq) const {
        const int row0 = u.pm * BM + wr * 64 + fr, col0 = u.pn * HALF + wc * 32 + 8 * fq;
#pragma unroll
        for (int ai = 0; ai < 2; ++ai)
#pragma unroll
            for (int m = 0; m < 4; ++m) { bf16_t* rowp = O + (size_t)(row0 + ai * HALF + m * 16) * ldc + col0;
                st8(rowp, silu4(acc[ai][0][m][0]) * acc[ai][1][m][0], silu4(acc[ai][0][m][1]) * acc[ai][1][m][1]); asm volatile("" ::: "memory"); }
    }
};

struct EpiWin {
    static constexpr bool PERM = true, AFTER_DRAIN = false;
    unsigned char* ws;
    __device__ __forceinline__ void operator()(const f32x4 (&acc)[2][2][4][2], const Unit& u, int wr, int wc, int fr, int fq) const {
        const int pn = u.pn, rowb = u.pm * BM + wr * 64 + fr, cw = wc * 32 + 8 * fq;
        bf16_t* const CQ = (bf16_t*)(ws + WS_CQ); bf16_t* const CKV = (bf16_t*)(ws + WS_CKV); bf16_t* const KR = (bf16_t*)(ws + WS_KR);
        float* const ssq_q = (float*)(ws + WS_SSQQ); float* const ssq_kv = (float*)(ws + WS_SSQKV); const float* const tabm = (const float*)(ws + WS_TABM); const float* const tabr = (const float*)(ws + WS_TABR);
        if (pn <= 2) {
#pragma unroll
            for (int ai = 0; ai < 2; ++ai)
#pragma unroll
                for (int m = 0; m < 4; ++m) { const size_t row = (size_t)(rowb + ai * HALF + m * 16);
                    const f32x4 a0 = acc[ai][0][m][0], a1 = acc[ai][0][m][1], b0 = acc[ai][1][m][0], b1 = acc[ai][1][m][1];
                    float sa = sq4(a0) + sq4(a1), sb = sq4(b0) + sq4(b1);
                    sa += __shfl_xor(sa, 16); sa += __shfl_xor(sa, 32); sb += __shfl_xor(sb, 16); sb += __shfl_xor(sb, 32);
                    if (pn == 0) { st8(CQ + row * 384 + cw, a0, a1); st8(CQ + row * 384 + 128 + cw, b0, b1); if (fq == 0) atomicAdd(ssq_q + row, sa + sb); }
                    else if (pn == 1) { st8(CQ + row * 384 + 256 + cw, a0, a1); st8(CKV + row * 256 + cw, b0, b1); if (fq == 0) { atomicAdd(ssq_q + row, sa); atomicAdd(ssq_kv + row, sb); } }
                    else { st8(CKV + row * 256 + 128 + cw, a0, a1); if (fq == 0) atomicAdd(ssq_kv + row, sa);
                        if (wc == 0) {
                            const f32x4 p0 = shx4(b0, 32), p1 = shx4(b1, 32);
                            const float* tb = tabm + row * 32 + 8 * (fq & 1);
                            const f32x4 c0 = *(const f32x4*)tb, c1 = *(const f32x4*)(tb + 4), s0 = *(const f32x4*)(tb + 16), s1 = *(const f32x4*)(tb + 20);
                            const float sg = (fq < 2) ? -1.f : 1.f;
                            st8(KR + row * 32 + 8 * fq, b0 * c0 + sg * (p0 * s0), b1 * c1 + sg * (p1 * s1)); } }
                    asm volatile("" ::: "memory"); }
        } else if (pn <= 4) {
            bf16_t* dst = (bf16_t*)(ws + ((pn == 3) ? WS_RQ : WS_RK)); const float sc = (pn == 3) ? 1.0f : 0.125f;
#pragma unroll
            for (int ai = 0; ai < 2; ++ai)
#pragma unroll
                for (int m = 0; m < 4; ++m) { const size_t row = (size_t)(rowb + ai * HALF + m * 16);
                    const f32x4 a0 = acc[ai][0][m][0] * sc, a1 = acc[ai][0][m][1] * sc, b0 = acc[ai][1][m][0] * sc, b1 = acc[ai][1][m][1] * sc;
                    const float* tb = tabr + row * 64 + 8 * fq;
                    const f32x4 c0 = *(const f32x4*)tb, c1 = *(const f32x4*)(tb + 4), s0 = *(const f32x4*)(tb + 32), s1 = *(const f32x4*)(tb + 36);
                    bf16_t* o = dst + row * 256 + 64 * wc + 8 * fq;
                    st8(o, a0 * c0 - b0 * s0, a1 * c1 - b1 * s1); st8(o + 32, b0 * c0 + a0 * s0, b1 * c1 + a1 * s1); asm volatile("" ::: "memory"); }
        } else {
            size_t doff; int ld, cb, act;
            if (pn < 7) { doff = WS_RV; ld = 512; cb = (pn - 5) * 256; act = 0; } else if (pn < 9) { doff = WS_SG; ld = 512; cb = (pn - 7) * 256; act = 1; }
            else if (pn < 13) { doff = WS_GM; ld = 1024; cb = (pn - 9) * 256; act = 2; } else { doff = WS_GR; ld = 1024; cb = (pn - 13) * 256; act = 2; }
            bf16_t* const dst = (bf16_t*)(ws + doff);
#pragma unroll
            for (int ai = 0; ai < 2; ++ai)
#pragma unroll
                for (int m = 0; m < 4; ++m) { bf16_t* o = dst + (size_t)(rowb + ai * HALF + m * 16) * ld + cb + cw;
#pragma unroll
                    for (int bj = 0; bj < 2; ++bj) { f32x4 v0 = acc[ai][bj][m][0], v1 = acc[ai][bj][m][1];
                        if (act == 1) { v0 = silu4(v0); v1 = silu4(v1); } else if (act == 2) { v0 = sigm4(v0); v1 = sigm4(v1); }
                        st8(o + bj * HALF, v0, v1); }
                    asm volatile("" ::: "memory"); }
        }
    }
};

struct EpiQup {
    static constexpr bool PERM = true, AFTER_DRAIN = false;
    bf16_t* Q; const float* ssq_q; const float* tabm; float c2q;
    __device__ __forceinline__ void operator()(const f32x4 (&acc)[2][2][4][2], const Unit& u, int wr, int wc, int fr_, int fq_) const {
        const int ln = fresh_lane(), fr = ln & 15, fq = ln >> 4;
        const int pn = u.pn, rowb = u.pm * BM + wr * 64 + fr, cw = wc * 32 + 8 * fq;
#pragma unroll
        for (int ai = 0; ai < 2; ++ai)
#pragma unroll
            for (int m = 0; m < 4; ++m) { const size_t row = (size_t)(rowb + ai * HALF + m * 16);
                const float rs = rsqrtf(ssq_q[row] * (1.0f / 384.0f) + 1e-6f) * c2q;
                const f32x4 a0 = acc[ai][0][m][0] * rs, a1 = acc[ai][0][m][1] * rs, b0 = acc[ai][1][m][0] * rs, b1 = acc[ai][1][m][1] * rs;
                if (pn < 2) { const int cg = 256 * pn + cw;
                    st8(Q + row * 768 + 96 * (cg >> 6) + (cg & 63), a0, a1); st8(Q + row * 768 + 96 * ((cg + 128) >> 6) + ((cg + 128) & 63), b0, b1); }
                else { const int head = 2 * wc + (fq >> 1), i0 = 8 * (fq & 1);
                    const float* tb = tabm + row * 32 + i0;
                    const f32x4 c0 = *(const f32x4*)tb, c1 = *(const f32x4*)(tb + 4), s0 = *(const f32x4*)(tb + 16), s1 = *(const f32x4*)(tb + 20);
                    bf16_t* o = Q + row * 768 + 96 * head + 64 + i0;
                    st8(o, a0 * c0 - b0 * s0, a1 * c1 - b1 * s1); st8(o + 16, b0 * c0 + a0 * s0, b1 * c1 + a1 * s1); }
                asm volatile("" ::: "memory"); }
    }
};
struct EpiKVup {
    static constexpr bool PERM = true, AFTER_DRAIN = false;
    unsigned char* ws; const float* ssq_kv;
    __device__ __forceinline__ void operator()(const f32x4 (&acc)[2][2][4][2], const Unit& u, int wr, int wc, int fr_, int fq_) const {
        const int ln = fresh_lane(), fr = ln & 15, fq = ln >> 4;
        const int rowb = u.pm * BM + wr * 64 + fr, cw = wc * 32 + 8 * fq;
        bf16_t* dst = (bf16_t*)(ws + ((wc < 2) ? WS_KN : WS_V)); const int cc = cw & 63;
#pragma unroll
        for (int ai = 0; ai < 2; ++ai)
#pragma unroll
            for (int m = 0; m < 4; ++m) { const size_t row = (size_t)(rowb + ai * HALF + m * 16);
                const float rs = rsqrtf(ssq_kv[row] * (1.0f / 256.0f) + 1e-6f);
#pragma unroll
                for (int bj = 0; bj < 2; ++bj) st8(dst + row * 512 + 64 * (2 * u.pn + bj) + cc, acc[ai][bj][m][0] * rs, acc[ai][bj][m][1] * rs);
                asm volatile("" ::: "memory"); }
    }
};
struct EpiGate1 {
    static constexpr bool PERM = true, AFTER_DRAIN = false;
    float* T1; const bf16_t* G;
    __device__ __forceinline__ void operator()(const f32x4 (&acc)[2][2][4][2], const Unit& u, int wr, int wc, int fr, int fq) const {
        const int rowb = u.pm * BM + wr * 64 + fr, col0 = u.pn * BM + wc * 32 + 8 * fq;
#pragma unroll
        for (int ai = 0; ai < 2; ++ai)
#pragma unroll
            for (int m = 0; m < 4; ++m) { const size_t off = (size_t)(rowb + ai * HALF + m * 16) * 1024 + col0;
#pragma unroll
                for (int bj = 0; bj < 2; ++bj) { const u32x4 g = *(const u32x4*)(G + off + bj * HALF);
                    *(f32x4*)(T1 + off + bj * HALF) = acc[ai][bj][m][0] * bf4_to_f32(g.x, g.y); *(f32x4*)(T1 + off + bj * HALF + 4) = acc[ai][bj][m][1] * bf4_to_f32(g.z, g.w); }
                asm volatile("" ::: "memory"); }
    }
};
struct EpiGate2 {
    static constexpr bool PERM = true, AFTER_DRAIN = false;
    const float* T1; const bf16_t* G; bf16_t* MG;
    __device__ __forceinline__ void operator()(const f32x4 (&acc)[2][2][4][2], const Unit& u, int wr, int wc, int fr, int fq) const {
        const int rowb = u.pm * BM + wr * 64 + fr, col0 = u.pn * BM + wc * 32 + 8 * fq;
#pragma unroll
        for (int ai = 0; ai < 2; ++ai)
#pragma unroll
            for (int m = 0; m < 4; ++m) { const size_t off = (size_t)(rowb + ai * HALF + m * 16) * 1024 + col0;
#pragma unroll
                for (int bj = 0; bj < 2; ++bj) { const u32x4 g = *(const u32x4*)(G + off + bj * HALF);
                    const f32x4 t0 = *(const f32x4*)(T1 + off + bj * HALF), t1 = *(const f32x4*)(T1 + off + bj * HALF + 4);
                    st8(MG + off + bj * HALF, t0 + acc[ai][bj][m][0] * bf4_to_f32(g.x, g.y), t1 + acc[ai][bj][m][1] * bf4_to_f32(g.z, g.w)); }
                asm volatile("" ::: "memory"); }
    }
};
template <class Epi, class Sched, bool ALIGN_EPI = false, bool SP2 = false>
__device__ __forceinline__ void gemm_phase(PG8_LAS unsigned char* lds, const Gemm g, const Sched& S, const Epi& E, int wv) {
    const int tid_ = tid_fresh(wv);
    const int tid = tid_, wid = wv, lane = tid & 63, wr = wid >> 2, wc = wid & 3, fr = lane & 15, fq = lane >> 4;
    const int K = g.K, nt = K / BK;
    unsigned voffA[2], voffB[2];
#pragma unroll
    for (int i = 0; i < 2; ++i) { int R, C; stage_rc(tid * 16 + i * 8192, R, C); const int Rb = Epi::PERM ? ((R & ~31) + perm32(R & 31)) : R;
        voffA[i] = (unsigned)(R * K + C) * 2u; voffB[i] = (unsigned)(Rb * K + C) * 2u; }
    const size_t kstep = (size_t)(BK * 2);
    const size_t hstep = (size_t)HALF * K * 2;
    const size_t tstep = 2 * hstep;
    const unsigned ldsw = (unsigned)wid * 1024u;
    const int aoff = lds_byte(wr * 64 + fr, fq * 8), boff = lds_byte(wc * 32 + fr, fq * 8);
#define PG8_SA(b, h) (((b) * 2 + (h)) * HTB)
#define PG8_SB(b, h) ((4 + (b) * 2 + (h)) * HTB)
#define PG8_STAGE(bufoff, gbase, voff) do { _Pragma("unroll") for (int _i = 0; _i < 2; ++_i) \
        __builtin_amdgcn_global_load_lds((const unsigned*)((const char*)(gbase) + (voff)[_i]), (PG8_LAS unsigned*)(lds + (bufoff) + ldsw + _i * 8192), 16, 0, 0); } while (0)
#define PG8_LDA(dst, b, h) do { _Pragma("unroll") for (int m = 0; m < 4; ++m) _Pragma("unroll") for (int k = 0; k < 2; ++k) dst[m][k] = *(const PG8_LAS bf16x8*)(lds + PG8_SA(b, h) + aoff + m * 2048 + k * 1024); } while (0)
#define PG8_LDB(dst, b, h) do { _Pragma("unroll") for (int n = 0; n < 2; ++n) _Pragma("unroll") for (int k = 0; k < 2; ++k) dst[n][k] = *(const PG8_LAS bf16x8*)(lds + PG8_SB(b, h) + boff + n * 2048 + k * 1024); } while (0)
#define PG8_MMA(ai, bj, At, Bt) do { __builtin_amdgcn_s_setprio(1); _Pragma("unroll") for (int m = 0; m < 4; ++m) _Pragma("unroll") for (int n = 0; n < 2; ++n) _Pragma("unroll") for (int k = 0; k < 2; ++k) \
        acc[ai][bj][m][n] = __builtin_amdgcn_mfma_f32_16x16x32_bf16(Bt[n][k], At[m][k], acc[ai][bj][m][n], 0, 0, 0); __builtin_amdgcn_s_setprio(0); } while (0)
#define PG8_WAIT_V(n) asm volatile("s_waitcnt vmcnt(" #n ")" ::: "memory")
#define PG8_WAIT_L(n) asm volatile("s_waitcnt lgkmcnt(" #n ")" ::: "memory")
#define PG8_BAR __builtin_amdgcn_s_barrier()
#define PG8_SCHED __builtin_amdgcn_sched_barrier(0)
    Unit cur, nxt; int ui = 0;
    if (!S.next(0, cur)) return;
    f32x4 acc[2][2][4][2];
#pragma unroll
    for (int a = 0; a < 2; ++a)
#pragma unroll
        for (int b = 0; b < 2; ++b)
#pragma unroll
            for (int m = 0; m < 4; ++m)
#pragma unroll
                for (int n = 0; n < 2; ++n) acc[a][b][m][n] = (f32x4){0.f, 0.f, 0.f, 0.f};
    bf16x8 At[4][2], B0[2][2], B1[2][2];
    const char* cA = (const char*)g.A + (size_t)cur.pm * tstep; const char* cB = (const char*)g.Bt + (size_t)cur.pn * tstep;
    S.a_ready(cur);
    if constexpr (SP2) {
        PG8_STAGE(PG8_SB(0, 0), cB, voffB); PG8_STAGE(PG8_SB(0, 1), cB + hstep, voffB); PG8_STAGE(PG8_SA(0, 0), cA, voffA); PG8_STAGE(PG8_SA(0, 1), cA + hstep, voffA);
        if (wr == 1) PG8_BAR;
        PG8_WAIT_V(2); PG8_BAR;
        PG8_STAGE(PG8_SB(1, 0), cB + kstep, voffB); PG8_STAGE(PG8_SA(1, 0), cA + kstep, voffA); PG8_STAGE(PG8_SB(1, 1), cB + hstep + kstep, voffB);
        PG8_WAIT_V(6); PG8_BAR;
    } else {
        PG8_STAGE(PG8_SB(0, 0), cB, voffB); PG8_STAGE(PG8_SA(0, 0), cA, voffA); PG8_STAGE(PG8_SB(0, 1), cB + hstep, voffB); PG8_STAGE(PG8_SA(0, 1), cA + hstep, voffA);
        if (wr == 1) PG8_BAR;
        PG8_WAIT_V(4); PG8_BAR;
        PG8_STAGE(PG8_SB(1, 0), cB + kstep, voffB); PG8_STAGE(PG8_SA(1, 0), cA + kstep, voffA); PG8_STAGE(PG8_SB(1, 1), cB + hstep + kstep, voffB);
        PG8_WAIT_V(6); PG8_BAR;
    }
    for (;;) {
        const bool has_next = S.next(ui + 1, nxt);
        const char* nA = has_next ? (const char*)g.A + (size_t)nxt.pm * tstep : cA; const char* nB = has_next ? (const char*)g.Bt + (size_t)nxt.pn * tstep : cB;
#pragma nounroll
        for (int t = 0; t < nt; t += 2) {
            const bool last = (t == nt - 2);
            const char* a1 = cA + (size_t)(t + 1) * kstep;
            const char* a2 = last ? nA : cA + (size_t)(t + 2) * kstep; const char* b2 = last ? nB : cB + (size_t)(t + 2) * kstep;
            const char* a3 = a2 + kstep; const char* b3 = b2 + kstep;
            if (last && has_next) S.a_ready(nxt);
            if constexpr (SP2) {
            PG8_LDB(B0, 0, 0); PG8_LDB(B1, 0, 1); PG8_SCHED; PG8_LDA(At, 0, 0); PG8_STAGE(PG8_SA(1, 1), a1 + hstep, voffA);
            PG8_WAIT_V(8); PG8_WAIT_L(0); PG8_BAR; PG8_MMA(0, 0, At, B0); PG8_MMA(0, 1, At, B1); PG8_BAR; PG8_SCHED;
            PG8_LDA(At, 0, 1); PG8_STAGE(PG8_SB(0, 0), b2, voffB); PG8_STAGE(PG8_SB(0, 1), b2 + hstep, voffB); PG8_STAGE(PG8_SA(0, 0), a2, voffA);
            PG8_WAIT_V(8); PG8_WAIT_L(0); PG8_BAR; PG8_MMA(1, 0, At, B0); PG8_MMA(1, 1, At, B1); PG8_BAR; PG8_SCHED;
            PG8_LDB(B0, 1, 0); PG8_LDB(B1, 1, 1); PG8_SCHED; PG8_LDA(At, 1, 0); PG8_STAGE(PG8_SA(0, 1), a2 + hstep, voffA);
            PG8_WAIT_V(8); PG8_WAIT_L(0); PG8_BAR; PG8_MMA(0, 0, At, B0); PG8_MMA(0, 1, At, B1); PG8_BAR; PG8_SCHED;
            PG8_LDA(At, 1, 1); PG8_STAGE(PG8_SB(1, 0), b3, voffB); PG8_STAGE(PG8_SB(1, 1), b3 + hstep, voffB); PG8_STAGE(PG8_SA(1, 0), a3, voffA);
            PG8_WAIT_V(8); PG8_WAIT_L(0); PG8_BAR; PG8_MMA(1, 0, At, B0); PG8_MMA(1, 1, At, B1); PG8_BAR; PG8_SCHED;
            } else {
            PG8_LDB(B0, 0, 0); PG8_SCHED; PG8_LDA(At, 0, 0); PG8_STAGE(PG8_SA(1, 1), a1 + hstep, voffA);
            PG8_WAIT_L(8); PG8_BAR; PG8_WAIT_L(0); PG8_MMA(0, 0, At, B0); PG8_BAR; PG8_SCHED;
            PG8_LDB(B1, 0, 1); PG8_STAGE(PG8_SB(0, 0), b2, voffB);
            PG8_BAR; PG8_WAIT_L(0); PG8_MMA(0, 1, At, B1); PG8_BAR;
            PG8_LDA(At, 0, 1); PG8_STAGE(PG8_SA(0, 0), a2, voffA);
            PG8_BAR; PG8_WAIT_L(0); PG8_MMA(1, 0, At, B0); PG8_BAR; PG8_SCHED;
            PG8_STAGE(PG8_SB(0, 1), b2 + hstep, voffB);
            PG8_WAIT_V(6); PG8_BAR; PG8_MMA(1, 1, At, B1); PG8_BAR;
            PG8_LDB(B0, 1, 0); PG8_SCHED; PG8_LDA(At, 1, 0); PG8_STAGE(PG8_SA(0, 1), a2 + hstep, voffA);
            PG8_WAIT_L(8); PG8_BAR; PG8_WAIT_L(0); PG8_MMA(0, 0, At, B0); PG8_BAR; PG8_SCHED;
            PG8_LDB(B1, 1, 1); PG8_STAGE(PG8_SB(1, 0), b3, voffB);
            PG8_BAR; PG8_WAIT_L(0); PG8_MMA(0, 1, At, B1); PG8_BAR;
            PG8_LDA(At, 1, 1); PG8_STAGE(PG8_SA(1, 0), a3, voffA);
            PG8_BAR; PG8_WAIT_L(0); PG8_MMA(1, 0, At, B0); PG8_BAR; PG8_SCHED;
            PG8_STAGE(PG8_SB(1, 1), b3 + hstep, voffB);
            PG8_WAIT_V(6); PG8_BAR; PG8_MMA(1, 1, At, B1); PG8_BAR;
            }
        }
        if constexpr (ALIGN_EPI) { if (wr == 0) PG8_BAR; }
        if constexpr (!Epi::AFTER_DRAIN) { E(acc, cur, wr, wc, fr, fq); S.done(cur); }
        if (!has_next) break;
#pragma unroll
        for (int a = 0; a < 2; ++a)
#pragma unroll
            for (int b = 0; b < 2; ++b)
#pragma unroll
                for (int m = 0; m < 4; ++m)
#pragma unroll
                    for (int n = 0; n < 2; ++n) acc[a][b][m][n] = (f32x4){0.f, 0.f, 0.f, 0.f};
        cur = nxt; cA = nA; cB = nB; ++ui;
        if constexpr (ALIGN_EPI) { if (wr == 1) PG8_BAR; }
    }
    PG8_WAIT_V(0);
    if constexpr (!ALIGN_EPI) { if (wr == 0) PG8_BAR; }
    PG8_BAR;
    if constexpr (Epi::AFTER_DRAIN) { E.fused(acc, cur, wr, wc, fr, fq, lds, wid, lane); S.done(cur); }
#undef PG8_SA
#undef PG8_SB
#undef PG8_STAGE
#undef PG8_LDA
#undef PG8_LDB
#undef PG8_MMA
#undef PG8_WAIT_V
#undef PG8_WAIT_L
#undef PG8_BAR
#undef PG8_SCHED
}
}

namespace att {
typedef unsigned short bf16;
using bf16x8 = __attribute__((ext_vector_type(8))) short;
using s16x4 = __attribute__((ext_vector_type(4))) short;
using f32x16 = __attribute__((ext_vector_type(16))) float;
using u32x4 = __attribute__((ext_vector_type(4))) unsigned;
constexpr int SEQ = 4096, QB = 256, KVBLK = 64;
constexpr int KT_BYTES = 12288, VT_BYTES = 8192, SLOT = KT_BYTES + VT_BYTES, LDS_WS = 2 * SLOT, LDS_BYTES = LDS_WS + 8 * 256;
#define ATT_SBAR() __builtin_amdgcn_sched_barrier(0)
__device__ __forceinline__ int crow(int r, int hi) { return (r & 3) + 8 * (r >> 2) + 4 * hi; }
__device__ __forceinline__ void glds16(const void* gsrc, unsigned lds_dst) { unsigned keep;
    asm volatile("s_mov_b32 %0, m0\n\ts_mov_b32 m0, %2\n\ts_nop 0\n\tglobal_load_lds_dwordx4 %1, off\n\ts_mov_b32 m0, %0" : "=&s"(keep) : "v"(gsrc), "s"(lds_dst) : "memory"); }
typedef float f32x2_t __attribute__((ext_vector_type(2))); typedef __bf16 bf16x2_t __attribute__((ext_vector_type(2)));
__device__ __forceinline__ unsigned cvtpk_s(float lo, float hi) { f32x2_t v = {lo, hi}; bf16x2_t b = __builtin_convertvector(v, bf16x2_t); return __builtin_bit_cast(unsigned, b); }
typedef __attribute__((address_space(3))) const char* lds_cptr;
#define ATT_MX3(a, b, c) __builtin_fmaxf(__builtin_fmaxf((a), (b)), (c))
__device__ __forceinline__ float rowmax(const f32x16& p0, const f32x16& p1) {
    float a = ATT_MX3(p0[0], p0[1], p1[0]), b = ATT_MX3(p0[2], p0[3], p1[1]); a = ATT_MX3(a, p1[2], p1[3]);
#pragma unroll
    for (int r = 4; r < 16; r += 4) { a = ATT_MX3(a, p0[r], p0[r + 1]); b = ATT_MX3(b, p0[r + 2], p0[r + 3]); a = ATT_MX3(a, p1[r], p1[r + 1]); b = ATT_MX3(b, p1[r + 2], p1[r + 3]); }
    float m = __builtin_fmaxf(a, b); m = __builtin_fmaxf(m, __shfl_xor(m, 32)); return m; }
__device__ __forceinline__ void cmask(f32x16& p0, f32x16& p1, int jb, int qrel, int hi) {
    const int kb = 64 * jb + 4 * hi;
#pragma unroll
    for (int r = 0; r < 16; ++r) { const int kv = kb + (r & 3) + 8 * (r >> 2); if (kv > qrel) p0[r] = -INFINITY; if (kv + 32 > qrel) p1[r] = -INFINITY; } }
__device__ __forceinline__ void pv(f32x16* o, int vb, bf16x8 pa0, bf16x8 pa1, bf16x8 pa2, bf16x8 pa3) {
#pragma unroll
    for (int d0 = 0; d0 < 2; ++d0) { s16x4 lo[4], hi[4];
#pragma unroll
        for (int ks = 0; ks < 4; ++ks) {
            asm volatile("ds_read_b64_tr_b16 %0,%1 offset:%c2" : "=&v"(lo[ks]) : "v"(vb), "i"(d0 * 4096 + ks * 1024) : "memory");
            asm volatile("ds_read_b64_tr_b16 %0,%1 offset:%c2" : "=&v"(hi[ks]) : "v"(vb), "i"(d0 * 4096 + ks * 1024 + 512) : "memory"); }
        asm volatile("s_waitcnt lgkmcnt(0)" ::: "memory"); ATT_SBAR();
#define ATT_PK(k) (bf16x8){lo[k][0], lo[k][1], lo[k][2], lo[k][3], hi[k][0], hi[k][1], hi[k][2], hi[k][3]}
        o[d0] = __builtin_amdgcn_mfma_f32_32x32x16_bf16(pa0, ATT_PK(0), o[d0], 0, 0, 0);
        o[d0] = __builtin_amdgcn_mfma_f32_32x32x16_bf16(pa1, ATT_PK(1), o[d0], 0, 0, 0);
        o[d0] = __builtin_amdgcn_mfma_f32_32x32x16_bf16(pa2, ATT_PK(2), o[d0], 0, 0, 0);
        o[d0] = __builtin_amdgcn_mfma_f32_32x32x16_bf16(pa3, ATT_PK(3), o[d0], 0, 0, 0);
#undef ATT_PK
    }
}
__device__ __forceinline__ void attn_unit(int b, int h, int qb, const bf16* Q, const bf16* KN, const bf16* KR, const bf16* V, bf16* AO, char* shm, int wv) {
    const int tid_ = tid_fresh(wv);
    const int tid = tid_, lane = tid & 63, r32 = lane & 31, hi = lane >> 5; const int wid = wv;
    const long rowbase = (long)b * SEQ; const int q0 = qb * QB; const int NT = (q0 + QB) / KVBLK;
    const unsigned lds0 = (unsigned)(uintptr_t)shm;
    const lds_cptr shm3 = (lds_cptr)shm;
    volatile __attribute__((address_space(3))) float* wsf = (volatile __attribute__((address_space(3))) float*)(shm3 + LDS_WS) + wid * 64;
    const bf16* ksrc = KN + (rowbase + lane) * 512 + h * 64 + wid * 8;
    const bf16* krsrc = KR + (rowbase + lane) * 32 + (wid & 3) * 8;
    const bf16* vsrc = V + (rowbase + 16 * (wid & 3) + (lane >> 2)) * 512 + h * 64 + (wid >> 2) * 32 + (lane & 3) * 8;
#define ATT_DMA(t, slot) do { glds16(ksrc + (long)(t) * KVBLK * 512, (unsigned)__builtin_amdgcn_readfirstlane(lds0 + (slot) + wid * 1024)); \
        if (wid < 4) glds16(krsrc + (long)(t) * KVBLK * 32, (unsigned)__builtin_amdgcn_readfirstlane(lds0 + (slot) + (8 + wid) * 1024)); \
        glds16(vsrc + (long)(t) * KVBLK * 512, (unsigned)__builtin_amdgcn_readfirstlane(lds0 + (slot) + KT_BYTES + wid * 1024)); } while (0)
    ATT_DMA(0, 0);
    const bf16* Qw = Q + (rowbase + q0 + wid * 32 + r32) * 768 + h * 96;
    bf16x8 qr[6];
#pragma unroll
    for (int d0 = 0; d0 < 6; ++d0) qr[d0] = *reinterpret_cast<const bf16x8*>(Qw + d0 * 16 + hi * 8);
    float m_run = -INFINITY, l_run = 0.f; f32x16 o[2]; o[0] = f32x16{}; o[1] = f32x16{};
    const int qrel = wid * 32 + r32;
    for (int t = 0; t < NT; ++t) {
        asm volatile("s_waitcnt vmcnt(0) lgkmcnt(0)\n\ts_barrier" ::: "memory");
        if (t + 1 < NT) ATT_DMA(t + 1, ((t + 1) & 1) * SLOT);
        const int slot = (t & 1) * SLOT;
        f32x16 p0 = f32x16{}, p1 = f32x16{};
        { const lds_cptr kb = shm3 + slot + hi * 1024 + r32 * 16;
#pragma unroll
          for (int d0 = 0; d0 < 6; ++d0) {
              const bf16x8 b0 = *(const __attribute__((address_space(3))) bf16x8*)(kb + d0 * 2048);
              const bf16x8 b1 = *(const __attribute__((address_space(3))) bf16x8*)(kb + d0 * 2048 + 512);
              p0 = __builtin_amdgcn_mfma_f32_32x32x16_bf16(b0, qr[d0], p0, 0, 0, 0); p1 = __builtin_amdgcn_mfma_f32_32x32x16_bf16(b1, qr[d0], p1, 0, 0, 0); } }
        if (t >= NT - 4) cmask(p0, p1, t - (NT - 4), qrel, hi);
        const float rm = rowmax(p0, p1);
        const float m_new = __builtin_fmaxf(m_run, rm);
        if (__any(m_new > m_run)) {
            const float alpha = __builtin_amdgcn_exp2f(m_run - m_new);
            l_run *= alpha; if (hi == 0) wsf[r32] = alpha;
            asm volatile("s_waitcnt lgkmcnt(0)" ::: "memory");
#pragma unroll
            for (int r = 0; r < 16; ++r) { const float f = wsf[crow(r, hi)]; o[0][r] *= f; o[1][r] *= f; }
            m_run = m_new;
        }
        float sacc = 0.f;
#pragma unroll
        for (int r = 0; r < 16; ++r) { p0[r] = __builtin_amdgcn_exp2f(p0[r] - m_run); p1[r] = __builtin_amdgcn_exp2f(p1[r] - m_run); sacc += p0[r] + p1[r]; }
        l_run += sacc;
        u32x4 w0 = (u32x4){cvtpk_s(p0[0], p0[1]), cvtpk_s(p0[2], p0[3]), cvtpk_s(p0[4], p0[5]), cvtpk_s(p0[6], p0[7])};
        u32x4 w1 = (u32x4){cvtpk_s(p0[8], p0[9]), cvtpk_s(p0[10], p0[11]), cvtpk_s(p0[12], p0[13]), cvtpk_s(p0[14], p0[15])};
        u32x4 w2 = (u32x4){cvtpk_s(p1[0], p1[1]), cvtpk_s(p1[2], p1[3]), cvtpk_s(p1[4], p1[5]), cvtpk_s(p1[6], p1[7])};
        u32x4 w3 = (u32x4){cvtpk_s(p1[8], p1[9]), cvtpk_s(p1[10], p1[11]), cvtpk_s(p1[12], p1[13]), cvtpk_s(p1[14], p1[15])};
        const int vb = (int)(lds0 + slot + KT_BYTES) + ((lane >> 4) & 1) * 32 + (lane & 3) * 8 + (4 * hi + ((lane & 15) >> 2)) * 64;
        ATT_SBAR();
        pv(o, vb, __builtin_bit_cast(bf16x8, w0), __builtin_bit_cast(bf16x8, w1), __builtin_bit_cast(bf16x8, w2), __builtin_bit_cast(bf16x8, w3));
    }
    l_run += __shfl_xor(l_run, 32);
    if (hi == 0) wsf[r32] = __builtin_amdgcn_rcpf(l_run);
    asm volatile("s_waitcnt lgkmcnt(0)" ::: "memory");
    bf16* Ow = AO + (rowbase + q0 + wid * 32) * 512 + h * 64;
#pragma unroll
    for (int r = 0; r < 16; ++r) { const float f = wsf[crow(r, hi)];
#pragma unroll
        for (int d0 = 0; d0 < 2; ++d0) Ow[(long)crow(r, hi) * 512 + d0 * 32 + r32] = (bf16)(cvtpk_s(o[d0][r] * f, 0.f) & 0xffffu); }
    asm volatile("s_waitcnt lgkmcnt(0)\n\ts_barrier" ::: "memory");
#undef ATT_DMA
}
#undef ATT_SBAR
#undef ATT_MX3
}

namespace ret {
typedef unsigned short bf16;
using bf16x8 = __attribute__((ext_vector_type(8))) short;
using f32x4 = __attribute__((ext_vector_type(4))) float;
using u32x4 = __attribute__((ext_vector_type(4))) unsigned;
using u32x2 = __attribute__((ext_vector_type(2))) unsigned;
#define RLAS __attribute__((address_space(3)))
constexpr int SEQ = 4096, CH = 128, NCH = 32, DK = 64, DV = 128;
constexpr int PKT = 136, PKS = 72;
__device__ __forceinline__ float bf2f(unsigned short v) { return __uint_as_float((unsigned)v << 16); }
__device__ __forceinline__ unsigned short f2bf(float f) { unsigned u = __float_as_uint(f); return (unsigned short)((u + 0x7fffu + ((u >> 16) & 1u)) >> 16); }
__device__ __forceinline__ float log2gamma(int h) { return log2f(1.0f - exp2f(-5.0f - (float)h)); }

__device__ __forceinline__ void load_vt(const bf16* Vg, RLAS bf16* VT, int tid) {
#pragma unroll
    for (int i = 0; i < 4; ++i) { const int c = tid + 512 * i, s = c >> 4, e0 = (c & 15) * 8;
        const u32x4 v = *(const u32x4*)(Vg + (size_t)s * 512 + e0);
        const unsigned w[4] = {v.x, v.y, v.z, v.w};
#pragma unroll
        for (int j = 0; j < 4; ++j) { VT[(e0 + 2 * j) * PKT + s] = (bf16)(w[j] & 0xffffu); VT[(e0 + 2 * j + 1) * PKT + s] = (bf16)(w[j] >> 16); } }
}

__device__ __forceinline__ void kvn_unit(int b, int h, int n, const bf16* RK, const bf16* RV, float* KVN, char* shm, int wv) {
    const int tid_ = tid_fresh(wv);
    const int tid = tid_, lane = tid & 63, wid = wv, l15 = lane & 15, lq = lane >> 4;
    RLAS bf16* KT = (RLAS bf16*)shm;
    RLAS bf16* VT = KT + 64 * PKT;
    const size_t row0 = (size_t)b * SEQ + (size_t)n * CH;
    const float lg = log2gamma(h);
#pragma unroll
    for (int i = 0; i < 2; ++i) { const int c = tid + 512 * i, s = c >> 3, d0 = (c & 7) * 8;
        const u32x4 v = *(const u32x4*)(RK + (row0 + s) * 256 + h * 64 + d0);
        const float z = exp2f((float)(CH - 1 - s) * lg);
        const unsigned w[4] = {v.x, v.y, v.z, v.w};
#pragma unroll
        for (int j = 0; j < 4; ++j) { KT[(d0 + 2 * j) * PKT + s] = f2bf(bf2f((bf16)(w[j] & 0xffffu)) * z); KT[(d0 + 2 * j + 1) * PKT + s] = f2bf(bf2f((bf16)(w[j] >> 16)) * z); } }
    load_vt(RV + row0 * 512 + h * 128, VT, tid);
    __syncthreads();
    f32x4 acc[4];
#pragma unroll
    for (int mt = 0; mt < 4; ++mt) acc[mt] = (f32x4){0.f, 0.f, 0.f, 0.f};
#pragma unroll
    for (int ks = 0; ks < 4; ++ks) {
        const bf16x8 bv = *(const RLAS bf16x8*)(VT + (16 * wid + l15) * PKT + 32 * ks + 8 * lq);
#pragma unroll
        for (int mt = 0; mt < 4; ++mt) { const bf16x8 av = *(const RLAS bf16x8*)(KT + (16 * mt + l15) * PKT + 32 * ks + 8 * lq);
            acc[mt] = __builtin_amdgcn_mfma_f32_16x16x32_bf16(av, bv, acc[mt], 0, 0, 0); } }
    float* out = KVN + ((size_t)((b * 4 + h) * NCH + n)) * (DK * DV);
#pragma unroll
    for (int mt = 0; mt < 4; ++mt)
#pragma unroll
        for (int r = 0; r < 4; ++r) out[(16 * mt + 4 * lq + r) * DV + 16 * wid + l15] = acc[mt][r];
    __syncthreads();
}

__device__ __forceinline__ void out_unit(int b, int h, int i, const bf16* RQ, const bf16* RK, const bf16* RV, const bf16* SG, const float* KVN, bf16* YG, char* shm, int wv) {
    const int tid_ = tid_fresh(wv);
    const int tid = tid_, lane = tid & 63, wid = wv, l15 = lane & 15, lq = lane >> 4;
    RLAS bf16* Ks = (RLAS bf16*)shm;
    RLAS bf16* VT = Ks + 128 * PKS;
    RLAS bf16* RT = VT + 128 * PKT;
    RLAS bf16* PW = RT + 128 * PKS + wid * (16 * PKT);
    const size_t row0 = (size_t)b * SEQ + (size_t)i * CH;
    const float lg = log2gamma(h);
    { const float dec = exp2f((float)CH * lg);
      f32x4 st[4];
#pragma unroll
      for (int k = 0; k < 4; ++k) st[k] = (f32x4){0.f, 0.f, 0.f, 0.f};
      const float* kv = KVN + ((size_t)((b * 4 + h) * NCH)) * (DK * DV) + 4 * tid;
      for (int j = 0; j < i; ++j) {
#pragma unroll
          for (int k = 0; k < 4; ++k) st[k] = st[k] * dec + *(const f32x4*)(kv + (size_t)j * (DK * DV) + 2048 * k); }
#pragma unroll
      for (int k = 0; k < 4; ++k) { const int idx = 4 * tid + 2048 * k, d = idx >> 7, e = idx & 127;
#pragma unroll
          for (int q = 0; q < 4; ++q) RT[(e + q) * PKS + d] = f2bf(st[k][q]); } }
#pragma unroll
    for (int k = 0; k < 2; ++k) { const int c = tid + 512 * k, s = c >> 3, d0 = (c & 7) * 8;
        *(RLAS u32x4*)(Ks + s * PKS + d0) = *(const u32x4*)(RK + (row0 + s) * 256 + h * 64 + d0); }
    load_vt(RV + row0 * 512 + h * 128, VT, tid);
    bf16x8 qf[2];
#pragma unroll
    for (int ks = 0; ks < 2; ++ks) qf[ks] = *(const bf16x8*)(RQ + (row0 + 16 * wid + l15) * 256 + h * 64 + 32 * ks + 8 * lq);
    __syncthreads();
#pragma unroll
    for (int nt = 0; nt < 8; ++nt) { f32x4 s = (f32x4){0.f, 0.f, 0.f, 0.f};
#pragma unroll
        for (int ks = 0; ks < 2; ++ks) { const bf16x8 kb = *(const RLAS bf16x8*)(Ks + (16 * nt + l15) * PKS + 32 * ks + 8 * lq);
            s = __builtin_amdgcn_mfma_f32_16x16x32_bf16(qf[ks], kb, s, 0, 0, 0); }
#pragma unroll
        for (int r = 0; r < 4; ++r) { const int c = 16 * wid + 4 * lq + r, sk = 16 * nt + l15, diff = c - sk;
            const float v = (diff >= 0) ? s[r] * exp2f((float)diff * lg) : 0.f;
            PW[(4 * lq + r) * PKT + sk] = f2bf(v); } }
    asm volatile("s_waitcnt lgkmcnt(0)" ::: "memory");
    bf16x8 pa[4];
#pragma unroll
    for (int ks = 0; ks < 4; ++ks) pa[ks] = *(const RLAS bf16x8*)(PW + l15 * PKT + 32 * ks + 8 * lq);
    f32x4 ya[8], ca[8];
#pragma unroll
    for (int nt = 0; nt < 8; ++nt) { ya[nt] = (f32x4){0.f, 0.f, 0.f, 0.f}; ca[nt] = (f32x4){0.f, 0.f, 0.f, 0.f};
#pragma unroll
        for (int ks = 0; ks < 4; ++ks) { const bf16x8 vb = *(const RLAS bf16x8*)(VT + (16 * nt + l15) * PKT + 32 * ks + 8 * lq);
            ya[nt] = __builtin_amdgcn_mfma_f32_16x16x32_bf16(pa[ks], vb, ya[nt], 0, 0, 0); }
#pragma unroll
        for (int ks = 0; ks < 2; ++ks) { const bf16x8 rb = *(const RLAS bf16x8*)(RT + (16 * nt + l15) * PKS + 32 * ks + 8 * lq);
            ca[nt] = __builtin_amdgcn_mfma_f32_16x16x32_bf16(qf[ks], rb, ca[nt], 0, 0, 0); } }
#pragma unroll
    for (int r = 0; r < 4; ++r) { const int c = 16 * wid + 4 * lq + r; const float xi = exp2f((float)(c + 1) * lg);
        float y[8]; float s1 = 0.f;
#pragma unroll
        for (int nt = 0; nt < 8; ++nt) { y[nt] = ya[nt][r] + xi * ca[nt][r]; s1 += y[nt]; }
        s1 += __shfl_xor(s1, 1); s1 += __shfl_xor(s1, 2); s1 += __shfl_xor(s1, 4); s1 += __shfl_xor(s1, 8);
        const float mean = s1 * (1.0f / 128.0f); float s2 = 0.f;
#pragma unroll
        for (int nt = 0; nt < 8; ++nt) { y[nt] -= mean; s2 += y[nt] * y[nt]; }
        s2 += __shfl_xor(s2, 1); s2 += __shfl_xor(s2, 2); s2 += __shfl_xor(s2, 4); s2 += __shfl_xor(s2, 8);
        const float rstd = rsqrtf(s2 * (1.0f / 128.0f) + 1e-6f);
        const size_t off = (row0 + c) * 512 + h * 128 + l15;
#pragma unroll
        for (int nt = 0; nt < 8; ++nt) YG[off + 16 * nt] = f2bf(y[nt] * rstd * bf2f(SG[off + 16 * nt])); }
    __syncthreads();
}
#undef RLAS
}

#define GAS __attribute__((address_space(1)))
#define LAS __attribute__((address_space(3)))
typedef unsigned short bf16;
typedef unsigned v4u __attribute__((ext_vector_type(4)));
typedef float f32x4 __attribute__((ext_vector_type(4)));
typedef short bf16x8 __attribute__((ext_vector_type(8)));
typedef GAS unsigned gu32;
typedef GAS unsigned long long gu64;
#define RLX_AGENT __ATOMIC_RELAXED, __HIP_MEMORY_SCOPE_AGENT
#define LDS_WAIT() asm volatile("s_waitcnt lgkmcnt(0)" ::: "memory")
#define VM_WAIT() asm volatile("s_waitcnt vmcnt(0)" ::: "memory")
__device__ __forceinline__ unsigned long long rt() { return __builtin_amdgcn_s_memrealtime(); }
__device__ __forceinline__ unsigned f2bf(float f) { unsigned u = __builtin_bit_cast(unsigned, f); return (u + 0x7fffu + ((u >> 16) & 1u)) >> 16; }
__device__ __forceinline__ unsigned pk2(float lo, float hi) { return f2bf(lo) | (f2bf(hi) << 16); }

#define XB_TMO      128
#define XB_XCNT(j)  (256  + 64 * (j))
#define XB_XSUB(j)  (1280 + 64 * (j))
#define XB_XGEN(j)  (2304 + 64 * (j))
#define XB_TOP      3328
#define XB_TOPGEN   3392
#define XCD_BAR_WORDS 3456
#define XB_SPIN_CAP (1u << 18)

__device__ __forceinline__ unsigned xb_ld(unsigned* p)              { return __hip_atomic_load(p, __ATOMIC_RELAXED, __HIP_MEMORY_SCOPE_AGENT); }
__device__ __forceinline__ unsigned xb_add(unsigned* p, unsigned v) { return __hip_atomic_fetch_add(p, v, __ATOMIC_RELAXED, __HIP_MEMORY_SCOPE_AGENT); }
__device__ __forceinline__ unsigned xb_xcc_id() { return (unsigned)__builtin_amdgcn_s_getreg((3 << 11) | 20) & 0xFu; }
#define XB_SPIN(cond, bar) do { unsigned _sp = 0; while (cond) { __builtin_amdgcn_s_sleep(1); \
    if ((++_sp & 255u) == 0u) { if (xb_ld(&(bar)[XB_TMO])) break; if (_sp > XB_SPIN_CAP) { atomicAdd(&(bar)[XB_TMO], 1u); break; } } } } while (0)

struct XcdBarrier {
    int wv; unsigned* bar; unsigned x;
    volatile LAS unsigned* st;
};

__device__ __forceinline__ XcdBarrier xcd_barrier_post(unsigned* bar, volatile LAS unsigned* st, int wv) {
    XcdBarrier b; b.wv = wv; b.bar = bar; b.x = xb_xcc_id(); b.st = st;
    if (tid_fresh(wv) == 0) (void)xb_add(&bar[XB_XCNT(b.x)], 1u);
    return b;
}
__device__ __forceinline__ void xcd_barrier_complete(unsigned* bar, unsigned x, unsigned& nloc, unsigned& nx) {
    const unsigned G = gridDim.x * gridDim.y * gridDim.z;
    unsigned sum, cnt, mine, sp = 0u;
    for (;;) {
        sum = 0u; cnt = 0u; mine = 0u;
#pragma unroll
        for (unsigned j = 0; j < 16; ++j) { const unsigned c = xb_ld(&bar[XB_XCNT(j)]); sum += c; cnt += (c > 0u) ? 1u : 0u; mine = (j == x) ? c : mine; }
        if (sum == G) break;
        __builtin_amdgcn_s_sleep(1);
        if ((++sp & 255u) == 0u) { if (xb_ld(&bar[XB_TMO])) break; if (sp > XB_SPIN_CAP) { atomicAdd(&bar[XB_TMO], 1u); break; } }
    }
    nloc = mine > 0u ? mine : 1u; nx = cnt > 0u ? cnt : 1u;
}

__device__ __forceinline__ void xcd_barrier(const XcdBarrier& b) {
    asm volatile("s_waitcnt vmcnt(0)" ::: "memory");
    __syncthreads();
    if (tid_fresh(b.wv) == 0) {
        unsigned* bar = b.bar;
        __builtin_amdgcn_s_waitcnt(0);
        unsigned nloc = b.st[0], nx = b.st[1];
        if (nloc == 0u) { xcd_barrier_complete(bar, b.x, nloc, nx); b.st[0] = nloc; b.st[1] = nx; }
        const unsigned old = xb_add(&bar[XB_XSUB(b.x)], 1u);
        const unsigned gen = old / nloc;
        if (old + 1u == (gen + 1u) * nloc) {
            __builtin_amdgcn_fence(__ATOMIC_RELEASE, "agent");
            asm volatile("s_waitcnt vmcnt(0)" ::: "memory");
            const unsigned og = xb_add(&bar[XB_TOP], 1u);
            const unsigned tg = og / nx;
            if (og + 1u == (tg + 1u) * nx) xb_add(&bar[XB_TOPGEN], 1u);
            else XB_SPIN(xb_ld(&bar[XB_TOPGEN]) == tg, bar);
            __builtin_amdgcn_fence(__ATOMIC_ACQUIRE, "agent");
            xb_add(&bar[XB_XGEN(b.x)], 1u);
            asm volatile("s_waitcnt vmcnt(0)" ::: "memory");
        } else {
            XB_SPIN(xb_ld(&bar[XB_XGEN(b.x)]) == gen, bar);
            __builtin_amdgcn_fence(__ATOMIC_ACQUIRE, "agent");
            asm volatile("s_waitcnt vmcnt(0)" ::: "memory");
        }
    }
    __syncthreads();
}


struct Args { const void* in[21]; float* out; unsigned char* ws; int ph_lo, ph_hi; };

__device__ __forceinline__ float wave_sum(float v) {
#pragma unroll
    for (int o = 1; o < 64; o <<= 1) v += __shfl_xor(v, o);
    return v;
}
template <class Map>
__device__ __forceinline__ void transpose_item(const float* W, int K, int N, bf16* WT, const float* gk, LAS float* scr, int item, int lane, const Map& map) {
    const int nblk = N / 32, kb = item / nblk, nb = item % nblk, k0 = 64 * kb, n0 = 32 * nb;
#pragma unroll 8
    for (int i = 0; i < 32; ++i) { const int kk = 2 * i + (lane >> 5); const float g = gk ? gk[k0 + kk] : 1.0f; scr[kk * 33 + (lane & 31)] = W[(size_t)(k0 + kk) * N + n0 + (lane & 31)] * g; }
    LDS_WAIT(); asm volatile("" ::: "memory");
    const int c = lane & 7;
#pragma unroll
    for (int j = 0; j < 4; ++j) { const int n = (lane >> 3) + 8 * j; const LAS float* s = scr + (8 * c) * 33 + n;
        v4u o; o.x = pk2(s[0 * 33], s[1 * 33]); o.y = pk2(s[2 * 33], s[3 * 33]); o.z = pk2(s[4 * 33], s[5 * 33]); o.w = pk2(s[6 * 33], s[7 * 33]);
        *(GAS v4u*)(WT + (size_t)map(n0 + n) * K + k0 + 8 * c) = o; }
    LDS_WAIT(); asm volatile("" ::: "memory");
}
struct MapId { __device__ __forceinline__ int operator()(int n) const { return n; } };
struct MapW1 { __device__ __forceinline__ int operator()(int n) const { return n < FF ? 256 * (n >> 7) + (n & 127) : 256 * ((n - FF) >> 7) + 128 + ((n - FF) & 127); } };
struct MapWin { __device__ __forceinline__ int operator()(int n) const {
    if (n < 672) return n;
    if (n < 1184) { const int base = n < 928 ? 768 : 1024, m = n < 928 ? n - 672 : n - 928, head = m >> 6, i = m & 63; return base + 128 * (i >> 5) + 32 * head + (i & 31); }
    if (n < 1696) return 1280 + (n - 1184);
    if (n < 2208) return 1792 + (n - 1696);
    if (n < 3232) return 2304 + (n - 2208);
    return 3328 + (n - 3232); } };
struct MapWuq { __device__ __forceinline__ int operator()(int n) const { const int head = n / 96, i = n - 96 * head; if (i < 64) return 64 * head + i; const int r = i - 64; return 512 + 128 * (r >> 4) + 16 * head + (r & 15); } };

__device__ __forceinline__ void rms_row_to_bf16(const float* xrow, bf16* orow, int lane) {
    const GAS f32x4* xr = (const GAS f32x4*)xrow + lane;
    f32x4 v[4]; float s = 0.f;
#pragma unroll
    for (int j = 0; j < 4; ++j) { v[j] = xr[64 * j]; s += (v[j].x * v[j].x + v[j].y * v[j].y) + (v[j].z * v[j].z + v[j].w * v[j].w); }
    const float rstd = rsqrtf(wave_sum(s) * (1.f / DM) + 1e-6f);
    GAS unsigned long long* o8 = (GAS unsigned long long*)orow + lane;
#pragma unroll
    for (int j = 0; j < 4; ++j) o8[64 * j] = (unsigned long long)pk2(v[j].x * rstd, v[j].y * rstd) | ((unsigned long long)pk2(v[j].z * rstd, v[j].w * rstd) << 32);
}
__device__ __forceinline__ void post_row(const float* frow, const float* brow, const float* pw, float coef, float* hrow, bf16* xnrow, int lane) {
    const GAS f32x4* fr = (const GAS f32x4*)frow + lane; const GAS f32x4* br = (const GAS f32x4*)brow + lane; const GAS f32x4* pr = (const GAS f32x4*)pw + lane;
    f32x4 v[4]; float s = 0.f;
#pragma unroll
    for (int j = 0; j < 4; ++j) { v[j] = fr[64 * j]; s += (v[j].x * v[j].x + v[j].y * v[j].y) + (v[j].z * v[j].z + v[j].w * v[j].w); }
    const float rstd = rsqrtf(wave_sum(s) * (1.f / DM) + 1e-6f) * coef;
    float s2 = 0.f;
#pragma unroll
    for (int j = 0; j < 4; ++j) { v[j] = br[64 * j] + (v[j] * rstd) * pr[64 * j]; s2 += (v[j].x * v[j].x + v[j].y * v[j].y) + (v[j].z * v[j].z + v[j].w * v[j].w); }
    GAS f32x4* hr = (GAS f32x4*)hrow + lane;
#pragma unroll
    for (int j = 0; j < 4; ++j) hr[64 * j] = v[j];
    if (xnrow) { const float r2 = rsqrtf(wave_sum(s2) * (1.f / DM) + 1e-6f);
        GAS unsigned long long* o8 = (GAS unsigned long long*)xnrow + lane;
#pragma unroll
        for (int j = 0; j < 4; ++j) o8[64 * j] = (unsigned long long)pk2(v[j].x * r2, v[j].y * r2) | ((unsigned long long)pk2(v[j].z * r2, v[j].w * r2) << 32); }
}

constexpr int NPHASE = 14;
__global__ void __launch_bounds__(NWAVES * 64, 2) mk_fwd(Args args) {
    __shared__ __attribute__((aligned(16))) unsigned char lds[LDS_TOTAL];
    LAS unsigned char* L = (LAS unsigned char*)lds;
    int wave_ = __builtin_amdgcn_readfirstlane(threadIdx.x >> 6); asm volatile("" : "+s"(wave_)); const int wave = wave_;
    const int G = gridDim.x, bx = blockIdx.x; const int vcu = (G % 8 == 0) ? (bx % 8) * (G / 8) + bx / 8 : bx;
    unsigned char* ws = args.ws;
    const float* x = (const float*)args.in[0]; const int* positions = (const int*)args.in[1];
    float* out = args.out;
    bf16 *W1A = (bf16*)(ws + WS_W1A), *W2A = (bf16*)(ws + WS_W2A), *WIN = (bf16*)(ws + WS_WIN), *WUQ = (bf16*)(ws + WS_WUQ), *WUKV = (bf16*)(ws + WS_WUKV), *WBM = (bf16*)(ws + WS_WBM),
         *WBR = (bf16*)(ws + WS_WBR), *WOUT = (bf16*)(ws + WS_WOUT), *W1B = (bf16*)(ws + WS_W1B), *W2B = (bf16*)(ws + WS_W2B);
    bf16 *XN = (bf16*)(ws + WS_XN), *HB = (bf16*)(ws + WS_H), *CQ = (bf16*)(ws + WS_CQ), *CKV = (bf16*)(ws + WS_CKV), *KR = (bf16*)(ws + WS_KR), *RQ = (bf16*)(ws + WS_RQ), *RK = (bf16*)(ws + WS_RK),
         *RV = (bf16*)(ws + WS_RV), *SG = (bf16*)(ws + WS_SG), *GM = (bf16*)(ws + WS_GM), *GR = (bf16*)(ws + WS_GR), *QB = (bf16*)(ws + WS_Q), *KN = (bf16*)(ws + WS_KN), *VB = (bf16*)(ws + WS_V),
         *AO = (bf16*)(ws + WS_AO), *YG = (bf16*)(ws + WS_YG), *MG = (bf16*)(ws + WS_MG);
    float *FB = (float*)(ws + WS_F), *T1 = (float*)(ws + WS_T1), *KVN = (float*)(ws + WS_KVN), *SSQQ = (float*)(ws + WS_SSQQ), *SSQKV = (float*)(ws + WS_SSQKV), *TABM = (float*)(ws + WS_TABM), *TABR = (float*)(ws + WS_TABR);

    { const int tid = tid_fresh(wave); for (int u = tid; u < (LDS_TOTAL - RING_BYTES) / 4; u += NWAVES * 64) ((LAS unsigned*)(L + RING_BYTES))[u] = 0u; }
    __syncthreads();
    const int lo = args.ph_lo, hi = args.ph_hi;
    const bool one_launch = (hi - lo) > 1;
    XcdBarrier bar; bar.wv = wave; bar.bar = (unsigned*)(ws + WS_CTL) + CW_BAR; bar.x = 0; bar.st = nullptr;
    if (one_launch) bar = xcd_barrier_post((unsigned*)(ws + WS_CTL) + CW_BAR, (volatile LAS unsigned*)(L + MISC_OFF) + 8, wave);
#ifdef PHASE_MASK
#define IN(k) (((PHASE_MASK >> (k)) & 1) && lo <= (k) && (k) < hi)
#else
#define IN(k) (lo <= (k) && (k) < hi)
#endif
#define SEAM(k) do { if (IN(k) && IN((k) + 1)) xcd_barrier(bar); } while (0)
    const int gw = vcu * NWAVES + wave, NGW = G * NWAVES;

    if (IN(0)) {
        const int tid = tid_fresh(wave), lane = tid & 63;
        LAS float* scr = (LAS float*)(L + wave * 16384);
        const float* g1 = (const float*)args.in[2]; const float* gmix = (const float*)args.in[6]; const float* gq = (const float*)args.in[8]; const float* gkv = (const float*)args.in[10];
        const float* ggn = (const float*)args.in[12]; const float* g2 = (const float*)args.in[17];
        constexpr int I_W1 = (DM / 64) * (2 * FF / 32), I_W2 = (FF / 64) * (DM / 32), I_WIN = (DM / 64) * (4256 / 32), I_WUQ = (384 / 64) * (768 / 32), I_WUKV = (256 / 64) * (1024 / 32),
                      I_WB = (512 / 64) * (1024 / 32), I_WOUT = (DM / 64) * (DM / 32);
        constexpr int NITEMS = 2 * I_W1 + 2 * I_W2 + I_WIN + I_WUQ + I_WUKV + 2 * I_WB + I_WOUT;
        for (int it = gw; it < NITEMS; it += NGW) {
            int r = it;
            if (r < I_W1) { transpose_item((const float*)args.in[3], DM, 2 * FF, W1A, g1, scr, r, lane, MapW1()); continue; } r -= I_W1;
            if (r < I_W1) { transpose_item((const float*)args.in[18], DM, 2 * FF, W1B, g2, scr, r, lane, MapW1()); continue; } r -= I_W1;
            if (r < I_W2) { transpose_item((const float*)args.in[4], FF, DM, W2A, nullptr, scr, r, lane, MapId()); continue; } r -= I_W2;
            if (r < I_W2) { transpose_item((const float*)args.in[19], FF, DM, W2B, nullptr, scr, r, lane, MapId()); continue; } r -= I_W2;
            if (r < I_WIN) { transpose_item((const float*)args.in[7], DM, 4256, WIN, gmix, scr, r, lane, MapWin()); continue; } r -= I_WIN;
            if (r < I_WUQ) { transpose_item((const float*)args.in[9], 384, 768, WUQ, gq, scr, r, lane, MapWuq()); continue; } r -= I_WUQ;
            if (r < I_WUKV) { transpose_item((const float*)args.in[11], 256, 1024, WUKV, gkv, scr, r, lane, MapId()); continue; } r -= I_WUKV;
            if (r < I_WB) { transpose_item((const float*)args.in[13], 512, 1024, WBM, nullptr, scr, r, lane, MapId()); continue; } r -= I_WB;
            if (r < I_WB) { transpose_item((const float*)args.in[14], 512, 1024, WBR, ggn, scr, r, lane, MapId()); continue; } r -= I_WB;
            transpose_item((const float*)args.in[15], DM, DM, WOUT, nullptr, scr, r, lane, MapId());
        }
        for (int i = gw * 64 + lane; i < 96 * DM / 8; i += NGW * 64) ((GAS v4u*)(WIN + (size_t)672 * DM))[i] = (v4u){0u, 0u, 0u, 0u};
        for (int m = gw; m < M_TOK; m += NGW) rms_row_to_bf16(x + (size_t)m * DM, XN + (size_t)m * DM, lane);
        for (int i = (vcu * NWAVES * 64 + tid); i < M_TOK * 48; i += G * NWAVES * 64) {
            const int row = i / 48, j = i - 48 * row; const bool mla = j < 16; const int k = mla ? j : j - 16; const float half = mla ? 16.f : 32.f;
            const float inv = exp2f(-((float)k / half) * 13.287712379549449f);
            const float ang = (float)positions[row] * inv;
            const double rev = (double)ang * 0.15915494309189535; const float fr = (float)(rev - __builtin_rint(rev));
            const float c = __builtin_amdgcn_cosf(fr), s = __builtin_amdgcn_sinf(fr);
            if (mla) { TABM[(size_t)row * 32 + k] = c; TABM[(size_t)row * 32 + 16 + k] = s; } else { TABR[(size_t)row * 64 + k] = c; TABR[(size_t)row * 64 + 32 + k] = s; }
        }
    }
    SEAM(0);
    if (IN(1)) { pg8::Gemm g{XN, W1A, M_TOK, 2 * FF, DM}; pg8::StaticOrder S; S.init(M_TOK, 2 * FF, G, bx); pg8::EpiSwiGLU E{HB, FF};
        pg8::gemm_phase<pg8::EpiSwiGLU, pg8::StaticOrder, true, true>(L, g, S, E, wave); }
    SEAM(1);
    if (IN(2)) { pg8::Gemm g{HB, W2A, M_TOK, DM, FF}; pg8::StaticOrder S; S.init(M_TOK, DM, G, bx); pg8::EpiF32 E{FB, DM};
        pg8::gemm_phase<pg8::EpiF32, pg8::StaticOrder, true, true>(L, g, S, E, wave); }
    SEAM(2);
    if (IN(3)) { const int lane = tid_fresh(wave) & 63; const float* pw = (const float*)args.in[5];
        for (int m = gw; m < M_TOK; m += NGW) post_row(FB + (size_t)m * DM, x + (size_t)m * DM, pw, 0.5f, out + (size_t)m * DM, XN + (size_t)m * DM, lane); }
    SEAM(3);
    if (IN(4)) { pg8::Gemm g{XN, WIN, M_TOK, NWIN, DM}; pg8::StaticOrder S; S.init(M_TOK, NWIN, G, bx);
        pg8::EpiWin E{ws};
        pg8::gemm_phase<pg8::EpiWin, pg8::StaticOrder, true, true>(L, g, S, E, wave); }
    SEAM(4);
    if (IN(5)) {
#if !defined(SUBMASK) || (SUBMASK & 1)
        { pg8::Gemm g{CQ, WUQ, M_TOK, 768, 384}; pg8::StaticOrder S; S.init(M_TOK, 768, G, bx); pg8::EpiQup E{QB, SSQQ, TABM, 0.10206207261596575f * 1.4426950408889634f};
          pg8::gemm_phase<pg8::EpiQup, pg8::StaticOrder, true, true>(L, g, S, E, wave); }
#endif
#if !defined(SUBMASK) || (SUBMASK & 2)
        { pg8::Gemm g{CKV, WUKV, M_TOK, 1024, 256}; pg8::StaticOrder S; S.init(M_TOK, 1024, G, bx); pg8::EpiKVup E{ws, SSQKV};
          pg8::gemm_phase<pg8::EpiKVup, pg8::StaticOrder, true, true>(L, g, S, E, wave); }
#endif
#if !defined(SUBMASK) || (SUBMASK & 4)
        for (int u = vcu; u < 1024; u += G) ret::kvn_unit(u >> 7, (u >> 5) & 3, u & 31, RK, RV, KVN, (char*)lds, wave);
#endif
    }
    SEAM(5);
    if (IN(6)) {
        for (int p = vcu; p < 512; p += G) { const int bh = p >> 3, s = p & 7;
            att::attn_unit(bh >> 3, bh & 7, 15 - s, QB, KN, KR, VB, AO, (char*)lds, wave);
            att::attn_unit(bh >> 3, bh & 7, s, QB, KN, KR, VB, AO, (char*)lds, wave); }
        for (int p = vcu; p < 512; p += G) { const int bh = p >> 4, ip = p & 15;
            ret::out_unit(bh >> 2, bh & 3, 31 - ip, RQ, RK, RV, SG, KVN, YG, (char*)lds, wave);
            ret::out_unit(bh >> 2, bh & 3, ip, RQ, RK, RV, SG, KVN, YG, (char*)lds, wave); }
    }
    SEAM(6);
    if (IN(7)) { pg8::Gemm g{AO, WBM, M_TOK, DM, 512}; pg8::StaticOrder S; S.init(M_TOK, DM, G, bx); pg8::EpiGate1 E{T1, GM};
        pg8::gemm_phase<pg8::EpiGate1, pg8::StaticOrder, true, true>(L, g, S, E, wave); }
    SEAM(7);
    if (IN(8)) { pg8::Gemm g{YG, WBR, M_TOK, DM, 512}; pg8::StaticOrder S; S.init(M_TOK, DM, G, bx); pg8::EpiGate2 E{T1, GR, MG};
        pg8::gemm_phase<pg8::EpiGate2, pg8::StaticOrder, true, true>(L, g, S, E, wave); }
    SEAM(8);
    if (IN(9)) { pg8::Gemm g{MG, WOUT, M_TOK, DM, DM}; pg8::StaticOrder S; S.init(M_TOK, DM, G, bx); pg8::EpiF32 E{FB, DM};
        pg8::gemm_phase<pg8::EpiF32, pg8::StaticOrder, true, true>(L, g, S, E, wave); }
    SEAM(9);
    if (IN(10)) { const int lane = tid_fresh(wave) & 63; const float* pw = (const float*)args.in[16];
        for (int m = gw; m < M_TOK; m += NGW) post_row(FB + (size_t)m * DM, out + (size_t)m * DM, pw, 1.0f, out + (size_t)m * DM, XN + (size_t)m * DM, lane); }
    SEAM(10);
    if (IN(11)) { pg8::Gemm g{XN, W1B, M_TOK, 2 * FF, DM}; pg8::StaticOrder S; S.init(M_TOK, 2 * FF, G, bx); pg8::EpiSwiGLU E{HB, FF};
        pg8::gemm_phase<pg8::EpiSwiGLU, pg8::StaticOrder, true, true>(L, g, S, E, wave); }
    SEAM(11);
    if (IN(12)) { pg8::Gemm g{HB, W2B, M_TOK, DM, FF}; pg8::StaticOrder S; S.init(M_TOK, DM, G, bx); pg8::EpiF32 E{FB, DM};
        pg8::gemm_phase<pg8::EpiF32, pg8::StaticOrder, true, true>(L, g, S, E, wave); }
    SEAM(12);
    if (IN(13)) { const int lane = tid_fresh(wave) & 63; const float* pw = (const float*)args.in[20];
        for (int m = gw; m < M_TOK; m += NGW) post_row(FB + (size_t)m * DM, out + (size_t)m * DM, pw, 0.5f, out + (size_t)m * DM, nullptr, lane); }
#undef IN
#undef SEAM
}

extern "C" void kernel_launch(void* const* d_in, const int* in_sizes, int n_in, void* d_out, int out_size, void* d_ws, size_t ws_size, hipStream_t stream) {
    static int grid = 0;
    if (grid == 0) {
        if (n_in != 21 || out_size != M_TOK * DM || ws_size < WS_END) { fprintf(stderr, "kernel_launch: unexpected shapes (n_in %d out %d ws %zu)\n", n_in, out_size, ws_size); grid = -1; return; }
        int dev = 0, cus = 0, per_cu = 0;
        hipGetDevice(&dev); hipDeviceGetAttribute(&cus, hipDeviceAttributeMultiprocessorCount, dev);
        hipOccupancyMaxActiveBlocksPerMultiprocessor(&per_cu, (const void*)mk_fwd, NWAVES * 64, 0);
        (void)hipGetLastError();
        grid = (per_cu >= 1) ? cus : 0; if (grid > 256) grid = 256;
        if (grid <= 0) { fprintf(stderr, "kernel_launch: occupancy query says %d blocks/CU on %d CUs\n", per_cu, cus); grid = -1; return; }
    }
    if (grid < 0) return;
    hipMemsetAsync((char*)d_ws + WS_CTL, 0, CTL_ZERO_BYTES, stream);
    Args a{};
    for (int i = 0; i < 21; ++i) a.in[i] = d_in[i];
    a.out = (float*)d_out; a.ws = (unsigned char*)d_ws;
#ifndef MK_ONE_LAUNCH
    for (int p = 0; p < NPHASE; ++p) { a.ph_lo = p; a.ph_hi = p + 1; hipLaunchKernelGGL(mk_fwd, dim3(grid), dim3(NWAVES * 64), 0, stream, a); }
#else
    a.ph_lo = 0; a.ph_hi = NPHASE; hipLaunchKernelGGL(mk_fwd, dim3(grid), dim3(NWAVES * 64), 0, stream, a);
#endif
}
```
